# Optimizing an MI355X kernel written in HIP

```python
import jax, jax.numpy as jnp
from jax import lax
import numpy as np

D_MODEL = 1024
BATCH = 2
SEQ = 8192
DEPTH = 2

N_MIXERS = 2
GLA_HEADS = 4
GLA_KEY_DIM = D_MODEL // 2
GLA_VAL_DIM = D_MODEL
GLA_HEAD_K = GLA_KEY_DIM // GLA_HEADS
GLA_HEAD_V = GLA_VAL_DIM // GLA_HEADS
GLA_GATE_RANK = 16
GLA_GATE_TAU = 16.0
GLA_CHUNK = 64
GLA_IN_DIM = 2 * GLA_KEY_DIM + 2 * GLA_VAL_DIM + GLA_GATE_RANK
SC_WIDTH = D_MODEL
CONV_WIDTH = 3
D_FF = ((8 * D_MODEL // 3 + 255) // 256) * 256
N_GLA = (DEPTH + 1) // 2
N_SC = DEPTH // 2
RMS_EPS = 1e-6

kernel_name = "hybrid_gla_shortconv_convffn"


def rmsnorm(x, g):
    x32 = x.astype(jnp.float32)
    y = x32 * lax.rsqrt(jnp.mean(x32 * x32, axis=-1, keepdims=True) + RMS_EPS)
    return y.astype(x.dtype) * g


def causal_dwconv(x, w):
    T = x.shape[1]
    K = w.shape[1]
    xp = jnp.pad(x, ((0, 0), (K - 1, 0), (0, 0)))
    y = xp[:, 0:T] * w[:, 0]
    for j in range(1, K):
        y = y + xp[:, j:j + T] * w[:, j]
    return y


def to_chunks(t, n_heads, head_dim):
    B, T, _ = t.shape
    n = T // GLA_CHUNK
    return t.reshape(B, n, GLA_CHUNK, n_heads, head_dim).transpose(0, 3, 1, 2, 4)


def gla_mixer(h, w_in, w_gate_up, b_gate, head_norm_g, w_out):
    B, T, _ = h.shape
    proj = h @ w_in
    s1 = GLA_KEY_DIM
    s2 = 2 * GLA_KEY_DIM
    s3 = s2 + GLA_VAL_DIM
    s4 = s3 + GLA_VAL_DIM
    q, k, v, g, a_low = proj[..., :s1], proj[..., s1:s2], proj[..., s2:s3], proj[..., s3:s4], proj[..., s4:]
    log_a = jax.nn.log_sigmoid((a_low @ w_gate_up + b_gate).astype(jnp.float32)) / GLA_GATE_TAU

    qc = to_chunks(q.astype(jnp.float32) * (GLA_HEAD_K ** -0.5), GLA_HEADS, GLA_HEAD_K)
    kc = to_chunks(k.astype(jnp.float32), GLA_HEADS, GLA_HEAD_K)
    vc = to_chunks(v.astype(jnp.float32), GLA_HEADS, GLA_HEAD_V)
    lc = to_chunks(log_a, GLA_HEADS, GLA_HEAD_K)

    bcum = jnp.cumsum(lc, axis=3)
    b_last = bcum[..., -1, :]
    q_in = qc * jnp.exp(bcum)
    k_in = kc * jnp.exp(-bcum)
    mask = jnp.tril(jnp.ones((GLA_CHUNK, GLA_CHUNK), dtype=bool))
    scores = jnp.where(mask, jnp.einsum('bhncd,bhnsd->bhncs', q_in, k_in), 0.0)
    o_intra = jnp.einsum('bhncs,bhnse->bhnce', scores, vc)
    k_dec = kc * jnp.exp(b_last[..., None, :] - bcum)
    chunk_kv = jnp.einsum('bhncd,bhnce->bhnde', k_dec, vc)

    def step(S, inp):
        q_n, kv_n, dec_n = inp
        o_n = jnp.einsum('bhcd,bhde->bhce', q_n, S)
        S = dec_n[..., None] * S + kv_n
        return S, o_n

    S0 = jnp.zeros((B, GLA_HEADS, GLA_HEAD_K, GLA_HEAD_V), jnp.float32)
    xs = (q_in.transpose(2, 0, 1, 3, 4), chunk_kv.transpose(2, 0, 1, 3, 4), jnp.exp(b_last).transpose(2, 0, 1, 3))
    _, o_inter = lax.scan(step, S0, xs)
    o = o_intra + o_inter.transpose(1, 2, 0, 3, 4)
    o = o.transpose(0, 2, 3, 1, 4).reshape(B, T, GLA_HEADS, GLA_HEAD_V)
    o = o * lax.rsqrt(jnp.mean(o * o, axis=-1, keepdims=True) + RMS_EPS)
    o = o.astype(h.dtype) * head_norm_g
    o = o.reshape(B, T, GLA_VAL_DIM) * jax.nn.silu(g)
    return o @ w_out


def short_conv_mixer(h, w_in, conv_w, w_out):
    proj = h @ w_in
    b, c, u = proj[..., :SC_WIDTH], proj[..., SC_WIDTH:2 * SC_WIDTH], proj[..., 2 * SC_WIDTH:]
    y = b * causal_dwconv(c * u, conv_w)
    return y @ w_out


def conv_ffn(h, w_up, conv_w, w_down):
    up = causal_dwconv(h @ w_up, conv_w)
    a, u = up[..., :D_FF], up[..., D_FF:]
    return (jax.nn.silu(a) * u) @ w_down


def setup_inputs(seed: int = 0) -> dict:
    key = jax.random.key(seed)
    ks = jax.random.split(key, 16)
    f32 = jnp.float32
    out_scale = (2.0 * DEPTH) ** -0.5
    nrm = lambda k, shape, s: jax.random.normal(k, shape, f32) * s
    return {
        "x": nrm(ks[0], (BATCH, SEQ, D_MODEL), 1.0),
        "norm_mix_g": 1.0 + nrm(ks[1], (DEPTH, D_MODEL), 0.02),
        "norm_ffn_g": 1.0 + nrm(ks[2], (DEPTH, D_MODEL), 0.02),
        "gla_w_in": nrm(ks[3], (N_GLA, D_MODEL, GLA_IN_DIM), D_MODEL ** -0.5),
        "gla_w_gate_up": nrm(ks[4], (N_GLA, GLA_GATE_RANK, GLA_KEY_DIM), GLA_GATE_RANK ** -0.5),
        "gla_b_gate": nrm(ks[5], (N_GLA, GLA_KEY_DIM), 0.1),
        "gla_head_norm_g": 1.0 + nrm(ks[6], (N_GLA, GLA_HEADS, GLA_HEAD_V), 0.02),
        "gla_w_out": nrm(ks[7], (N_GLA, GLA_VAL_DIM, D_MODEL), GLA_VAL_DIM ** -0.5 * out_scale),
        "sc_w_in": nrm(ks[8], (N_SC, D_MODEL, 3 * SC_WIDTH), D_MODEL ** -0.5),
        "sc_conv_w": nrm(ks[9], (N_SC, SC_WIDTH, CONV_WIDTH), CONV_WIDTH ** -0.5),
        "sc_w_out": nrm(ks[10], (N_SC, SC_WIDTH, D_MODEL), SC_WIDTH ** -0.5 * out_scale),
        "ffn_w_up": nrm(ks[11], (DEPTH, D_MODEL, 2 * D_FF), D_MODEL ** -0.5),
        "ffn_conv_w": nrm(ks[12], (DEPTH, 2 * D_FF, CONV_WIDTH), CONV_WIDTH ** -0.5),
        "ffn_w_down": nrm(ks[13], (DEPTH, D_FF, D_MODEL), D_FF ** -0.5 * out_scale),
        "final_norm_g": 1.0 + nrm(ks[14], (D_MODEL,), 0.02),
    }


def reference(x, norm_mix_g, norm_ffn_g, gla_w_in, gla_w_gate_up, gla_b_gate, gla_head_norm_g, gla_w_out,
              sc_w_in, sc_conv_w, sc_w_out, ffn_w_up, ffn_conv_w, ffn_w_down, final_norm_g):
    for i in range(DEPTH):
        h = rmsnorm(x, norm_mix_g[i])
        j = i // N_MIXERS
        if i % N_MIXERS == 0:
            x = x + gla_mixer(h, gla_w_in[j], gla_w_gate_up[j], gla_b_gate[j], gla_head_norm_g[j], gla_w_out[j])
        else:
            x = x + short_conv_mixer(h, sc_w_in[j], sc_conv_w[j], sc_w_out[j])
        h = rmsnorm(x, norm_ffn_g[i])
        x = x + conv_ffn(h, ffn_w_up[i], ffn_conv_w[i], ffn_w_down[i])
    return rmsnorm(x, final_norm_g)
```

```cpp
#include <hip/hip_runtime.h>
#include <cstdint>
#include <cstdio>

namespace v0 {
constexpr int B = 2, T = 8192, M = B * T, D = 1024, DFF = 2816, NUP = 2 * DFF;
constexpr int KD = 512, VD = 1024, H = 4, HK = 128, HV = 256, GR = 16, NIN = 2 * KD + 2 * VD + GR;
constexpr float EPS = 1e-6f;
typedef unsigned short bf16;
__device__ __forceinline__ float bf2f(bf16 v) { return __uint_as_float(((unsigned)v) << 16); }
__device__ __forceinline__ bf16 f2bf(float f) { unsigned u = __float_as_uint(f); return (bf16)((u + 0x7fffu + ((u >> 16) & 1u)) >> 16); }
__device__ __forceinline__ float silu(float x) { return x / (1.f + __expf(-x)); }

__global__ void k_rstd(const float* __restrict__ X, float* __restrict__ rstd) {
    const int row = blockIdx.x * 4 + (threadIdx.x >> 6), lane = threadIdx.x & 63;
    const float4* p = (const float4*)(X + (size_t)row * D);
    float s = 0.f;
    for (int j = 0; j < 4; ++j) { float4 v = p[lane + 64 * j]; s += v.x * v.x + v.y * v.y + v.z * v.z + v.w * v.w; }
    for (int o = 32; o; o >>= 1) s += __shfl_xor(s, o);
    if (lane == 0) rstd[row] = rsqrtf(s * (1.f / D) + EPS);
}

struct ANorm { const float* X; const float* rstd; const float* g;
    __device__ float operator()(int t, int k) const { return X[(size_t)t * D + k] * rstd[t] * g[k]; } };
struct AGla { const float* O; const float* hr; const float* hg; const bf16* P;
    __device__ float operator()(int t, int k) const { float o = O[(size_t)t * VD + k] * hr[t * H + (k >> 8)] * hg[k]; float g = bf2f(P[(size_t)t * 3072 + 2048 + k]); return o * silu(g); } };
struct ASc { const bf16* P; const float* cw;
    __device__ float operator()(int t, int k) const {
        const int tt = t & (T - 1); float acc = 0.f;
        for (int j = 0; j < 3; ++j) { int dt = 2 - j; if (tt - dt >= 0) { const bf16* r = P + (size_t)(t - dt) * 3072; acc += cw[k * 3 + j] * (bf2f(r[1024 + k]) * bf2f(r[2048 + k])); } }
        return bf2f(P[(size_t)t * 3072 + k]) * acc; } };
struct AFfn { const bf16* U; const float* cw;
    __device__ float operator()(int t, int k) const {
        const int tt = t & (T - 1); float a = 0.f, u = 0.f;
        for (int j = 0; j < 3; ++j) { int dt = 2 - j; if (tt - dt >= 0) { const bf16* r = U + (size_t)(t - dt) * NUP; a += cw[k * 3 + j] * bf2f(r[k]); u += cw[(DFF + k) * 3 + j] * bf2f(r[DFF + k]); } }
        return silu(a) * u; } };
struct EBf { bf16* C; float* extra; int ldc; int extra0;
    __device__ void operator()(int t, int n, float v) const { if (n < extra0) C[(size_t)t * ldc + n] = f2bf(v); else extra[(size_t)t * 16 + (n - extra0)] = v; } };
struct ERes { float* X;
    __device__ void operator()(int t, int n, float v) const { X[(size_t)t * D + n] += v; } };

template <class AL, class EP>
__global__ void __launch_bounds__(256) k_gemm(AL al, const float* __restrict__ W, int K, int N, EP ep) {
    __shared__ float As[16][68], Bs[16][68];
    const int tx = threadIdx.x & 15, ty = threadIdx.x >> 4, m0 = blockIdx.y * 64, n0 = blockIdx.x * 64;
    float acc[4][4] = {};
    for (int k0 = 0; k0 < K; k0 += 16) {
        for (int i = threadIdx.x; i < 1024; i += 256) { int kk = i & 15, mm = i >> 4; As[kk][mm] = al(m0 + mm, k0 + kk); }
        for (int i = threadIdx.x; i < 1024; i += 256) { int nn = i & 63, kk = i >> 6; int n = n0 + nn; Bs[kk][nn] = n < N ? W[(size_t)(k0 + kk) * N + n] : 0.f; }
        __syncthreads();
#pragma unroll
        for (int kk = 0; kk < 16; ++kk) {
            float a[4], b[4];
#pragma unroll
            for (int i = 0; i < 4; ++i) { a[i] = As[kk][ty * 4 + i]; b[i] = Bs[kk][tx * 4 + i]; }
#pragma unroll
            for (int i = 0; i < 4; ++i)
#pragma unroll
                for (int j = 0; j < 4; ++j) acc[i][j] += a[i] * b[j];
        }
        __syncthreads();
    }
    for (int i = 0; i < 4; ++i) for (int j = 0; j < 4; ++j) { int n = n0 + tx * 4 + j; if (n < N) ep(m0 + ty * 4 + i, n, acc[i][j]); }
}

__global__ void k_alpha(const float* __restrict__ alow, const float* __restrict__ Wg, const float* __restrict__ bg, float* __restrict__ alpha) {
    const size_t i = (size_t)blockIdx.x * 256 + threadIdx.x; const int t = (int)(i / KD), c = (int)(i % KD);
    float x = bg[c];
    for (int r = 0; r < GR; ++r) x += alow[(size_t)t * 16 + r] * Wg[r * KD + c];
    const float ls = fminf(x, 0.f) - log1pf(__expf(-fabsf(x)));
    alpha[i] = __expf(ls * (1.f / 16.f));
}
__global__ void __launch_bounds__(64) k_gla(const bf16* __restrict__ P, const float* __restrict__ alpha, float* __restrict__ O) {
    constexpr int TS = 8;
    __shared__ float sa[TS][HK], sk[TS][HK], sq[TS][HK];
    const int eg = blockIdx.x & 3, h = (blockIdx.x >> 2) & 3, b = blockIdx.x >> 4, e = eg * 64 + threadIdx.x;
    float S[HK];
#pragma unroll
    for (int d = 0; d < HK; ++d) S[d] = 0.f;
    const float scale = 0.08838834764831845f;
    for (int t0 = 0; t0 < T; t0 += TS) {
        __syncthreads();
        for (int i = threadIdx.x; i < TS * HK; i += 64) { int s = i >> 7, d = i & 127; size_t t = (size_t)b * T + t0 + s;
            sa[s][d] = alpha[t * KD + h * HK + d]; sq[s][d] = bf2f(P[t * 3072 + h * HK + d]) * scale; sk[s][d] = bf2f(P[t * 3072 + KD + h * HK + d]); }
        __syncthreads();
        for (int s = 0; s < TS; ++s) { size_t t = (size_t)b * T + t0 + s;
            const float v = bf2f(P[t * 3072 + 2 * KD + h * HV + e]); float o = 0.f;
#pragma unroll
            for (int d = 0; d < HK; ++d) { S[d] = sa[s][d] * S[d] + sk[s][d] * v; o += sq[s][d] * S[d]; }
            O[t * VD + h * HV + e] = o; }
    }
}
__global__ void k_headrstd(const float* __restrict__ O, float* __restrict__ hr) {
    const int idx = blockIdx.x * 4 + (threadIdx.x >> 6), lane = threadIdx.x & 63;
    const float4 v = ((const float4*)(O + (size_t)idx * HV))[lane];
    float s = v.x * v.x + v.y * v.y + v.z * v.z + v.w * v.w;
    for (int o = 32; o; o >>= 1) s += __shfl_xor(s, o);
    if (lane == 0) hr[idx] = rsqrtf(s * (1.f / HV) + EPS);
}
__global__ void k_copy(const float4* __restrict__ a, float4* __restrict__ b) { size_t i = (size_t)blockIdx.x * 256 + threadIdx.x; b[i] = a[i]; }
__global__ void k_final(float* __restrict__ X, const float* __restrict__ rstd, const float* __restrict__ g) {
    size_t i = (size_t)blockIdx.x * 256 + threadIdx.x; int t = (int)(i / D), k = (int)(i % D); X[i] = X[i] * rstd[t] * g[k];
}
}

extern "C" void kernel_launch(void* const* d_in, const int* in_sizes, int n_in, void* d_out, int out_size, void* d_ws, size_t ws_size, hipStream_t stream) {
    using namespace v0;
    const float* x = (const float*)d_in[0]; const float* nmg = (const float*)d_in[1]; const float* nfg = (const float*)d_in[2];
    const float* gwin = (const float*)d_in[3]; const float* gwg = (const float*)d_in[4]; const float* gbg = (const float*)d_in[5]; const float* ghg = (const float*)d_in[6]; const float* gwo = (const float*)d_in[7];
    const float* swin = (const float*)d_in[8]; const float* scw = (const float*)d_in[9]; const float* swo = (const float*)d_in[10];
    const float* fup = (const float*)d_in[11]; const float* fcw = (const float*)d_in[12]; const float* fdn = (const float*)d_in[13]; const float* fng = (const float*)d_in[14];
    float* X = (float*)d_out; char* ws = (char*)d_ws; const size_t MiB = 1u << 20;
    bf16* BIG = (bf16*)ws;
    float* O = (float*)(ws + 96 * MiB); float* ALPHA = (float*)(ws + 160 * MiB);
    float* ALOW = (float*)(ws + 250 * MiB); float* RSTD = (float*)(ws + 252 * MiB); float* HR = (float*)(ws + 253 * MiB);
    k_copy<<<M * D / 4 / 256, 256, 0, stream>>>((const float4*)x, (float4*)X);
    for (int layer = 0; layer < 2; ++layer) {
        k_rstd<<<M / 4, 256, 0, stream>>>(X, RSTD);
        if (layer == 0) {
            k_gemm<<<dim3((NIN + 63) / 64, M / 64), 256, 0, stream>>>(ANorm{X, RSTD, nmg}, gwin, D, NIN, EBf{BIG, ALOW, 3072, 3072});
            k_alpha<<<M * KD / 256, 256, 0, stream>>>(ALOW, gwg, gbg, ALPHA);
            k_gla<<<B * H * 4, 64, 0, stream>>>(BIG, ALPHA, O);
            k_headrstd<<<M * H / 4, 256, 0, stream>>>(O, HR);
            k_gemm<<<dim3(D / 64, M / 64), 256, 0, stream>>>(AGla{O, HR, ghg, BIG}, gwo, VD, D, ERes{X});
        } else {
            k_gemm<<<dim3(3072 / 64, M / 64), 256, 0, stream>>>(ANorm{X, RSTD, nmg + D}, swin, D, 3072, EBf{BIG, nullptr, 3072, 1 << 30});
            k_gemm<<<dim3(D / 64, M / 64), 256, 0, stream>>>(ASc{BIG, scw}, swo, D, D, ERes{X});
        }
        k_rstd<<<M / 4, 256, 0, stream>>>(X, RSTD);
        k_gemm<<<dim3(NUP / 64, M / 64), 256, 0, stream>>>(ANorm{X, RSTD, nfg + layer * D}, fup + (size_t)layer * D * NUP, D, NUP, EBf{BIG, nullptr, NUP, 1 << 30});
        k_gemm<<<dim3(D / 64, M / 64), 256, 0, stream>>>(AFfn{BIG, fcw + (size_t)layer * NUP * 3}, fdn + (size_t)layer * DFF * D, DFF, D, ERes{X});
    }
    k_rstd<<<M / 4, 256, 0, stream>>>(X, RSTD);
    k_final<<<M * D / 256, 256, 0, stream>>>(X, RSTD, fng);
}
```
